# Optimizing an MI355X kernel written in HIP

```python
import math
import jax, jax.numpy as jnp
from jax import lax
import numpy as np

D_MODEL = 1024
BATCH = 4
SEQ = 4096
DEPTH = 1

HEAD_DIM = 64
N_HEADS = D_MODEL // HEAD_DIM
N_DIFF_HEADS = N_HEADS // 4
DIFF_WIDTH = N_DIFF_HEADS * 2 * HEAD_DIM
N_MOBA_HEADS = N_HEADS // 2
MOBA_WIDTH = N_MOBA_HEADS * HEAD_DIM
MIX_WIDTH = DIFF_WIDTH + MOBA_WIDTH
ROT_DIM = HEAD_DIM // 4
ROPE_THETA = 500000.0
MOBA_BLOCK = 256
MOBA_TOPK = 3
MOBA_Q_CHUNK = 32
DIFF_Q_BLOCK = 128
D_FF = -(-8 * D_MODEL // (3 * 256)) * 256
ALPHA = (2.0 * DEPTH) ** 0.25
BETA = (8.0 * DEPTH) ** -0.25
LN_EPS = 1e-5

kernel_name = "hymba_diffattn_moba_deepnorm"


def lambda_init_for(layer_idx):
    return 0.8 - 0.6 * math.exp(-0.3 * layer_idx)


def rope_tables(seq):
    inv = ROPE_THETA ** (-jnp.arange(0, ROT_DIM, 2, dtype=jnp.float32) / ROT_DIM)
    ang = jnp.arange(seq, dtype=jnp.float32)[:, None] * inv[None, :]
    return jnp.cos(ang), jnp.sin(ang)


def partial_rope(x, cos, sin):
    half = ROT_DIM // 2
    x1 = x[..., :half].astype(jnp.float32)
    x2 = x[..., half:ROT_DIM].astype(jnp.float32)
    rot = jnp.concatenate([x1 * cos - x2 * sin, x2 * cos + x1 * sin], axis=-1).astype(x.dtype)
    return jnp.concatenate([rot, x[..., ROT_DIM:]], axis=-1)


def layer_norm(x, g, b):
    xf = x.astype(jnp.float32)
    mu = jnp.mean(xf, axis=-1, keepdims=True)
    var = jnp.mean(jnp.square(xf - mu), axis=-1, keepdims=True)
    return ((xf - mu) * lax.rsqrt(var + LN_EPS) * g.astype(jnp.float32) + b.astype(jnp.float32)).astype(x.dtype)


def diff_attention(q, k, v, lam_params, subln_g, lambda_init, cos, sin):
    B, S, _ = q.shape
    H, dh = N_DIFF_HEADS, HEAD_DIM
    q = q.reshape(B, S, H, 2, dh).transpose(0, 2, 3, 1, 4)
    k = k.reshape(B, S, H, 2, dh).transpose(0, 2, 3, 1, 4)
    v = v.reshape(B, S, H, 2 * dh).transpose(0, 2, 1, 3)
    q = partial_rope(q, cos, sin)
    k = partial_rope(k, cos, sin)
    lp = lam_params.astype(jnp.float32)
    lam = jnp.exp(jnp.sum(lp[0] * lp[1])) - jnp.exp(jnp.sum(lp[2] * lp[3])) + lambda_init
    scale = dh ** -0.5
    nblk = S // DIFF_Q_BLOCK
    qb = q.reshape(B, H, 2, nblk, DIFF_Q_BLOCK, dh).transpose(3, 0, 1, 2, 4, 5)
    kpos = jnp.arange(S)

    def one_block(args):
        qblk, i = args
        qpos = i * DIFF_Q_BLOCK + jnp.arange(DIFF_Q_BLOCK)
        s = jnp.einsum('bhcqd,bhckd->bhcqk', qblk, k).astype(jnp.float32) * scale
        s = jnp.where(kpos[None, :] <= qpos[:, None], s, -jnp.inf)
        p = jax.nn.softmax(s, axis=-1)
        a = p[:, :, 0] - lam * p[:, :, 1]
        return jnp.einsum('bhqk,bhkd->bhqd', a.astype(v.dtype), v)

    o = lax.map(one_block, (qb, jnp.arange(nblk)))
    o = o.transpose(1, 2, 0, 3, 4).reshape(B, H, S, 2 * dh)
    of = o.astype(jnp.float32)
    of = of * lax.rsqrt(jnp.mean(jnp.square(of), axis=-1, keepdims=True) + LN_EPS)
    of = of * subln_g.astype(jnp.float32) * (1.0 - lambda_init)
    return of.astype(v.dtype).transpose(0, 2, 1, 3).reshape(B, S, DIFF_WIDTH)


def moba_attention(q, k, v, cos, sin):
    B, S, _ = q.shape
    H, dh, BS, QC = N_MOBA_HEADS, HEAD_DIM, MOBA_BLOCK, MOBA_Q_CHUNK
    q = partial_rope(q.reshape(B, S, H, dh).transpose(0, 2, 1, 3), cos, sin)
    k = partial_rope(k.reshape(B, S, H, dh).transpose(0, 2, 1, 3), cos, sin)
    v = v.reshape(B, S, H, dh).transpose(0, 2, 1, 3)
    nb = -(-S // BS)
    pad = nb * BS - S
    k = jnp.pad(k, ((0, 0), (0, 0), (0, pad), (0, 0)))
    v = jnp.pad(v, ((0, 0), (0, 0), (0, pad), (0, 0)))
    kb = k.reshape(B, H, nb, BS, dh)
    vb = v.reshape(B, H, nb, BS, dh)
    kmean = jnp.mean(kb.astype(jnp.float32), axis=3).astype(k.dtype)
    topk = min(MOBA_TOPK, nb)
    scale = dh ** -0.5
    nc = S // QC
    qc = q.reshape(B, H, nc, QC, dh).transpose(2, 0, 1, 3, 4)
    blk_ids = jnp.arange(nb)
    gather = jax.vmap(jax.vmap(lambda blocks, idx: blocks[idx]))

    def one_chunk(args):
        qch, c = args
        start = c * QC
        qpos = start + jnp.arange(QC)
        own = start // BS
        gate = jnp.einsum('bhqd,bhnd->bhqn', qch, kmean).astype(jnp.float32)
        gate = jnp.where(blk_ids < own, gate, -jnp.inf)
        _, idx = lax.top_k(gate, topk)
        valid = jnp.arange(topk) < own
        k_sel = gather(kb, idx)
        v_sel = gather(vb, idx)
        s_sel = jnp.einsum('bhqd,bhqjkd->bhqjk', qch, k_sel).astype(jnp.float32) * scale
        s_sel = jnp.where(valid[:, None], s_sel, -jnp.inf).reshape(B, H, QC, topk * BS)
        k_own = lax.dynamic_index_in_dim(kb, own, axis=2, keepdims=False)
        v_own = lax.dynamic_index_in_dim(vb, own, axis=2, keepdims=False)
        kpos_own = own * BS + jnp.arange(BS)
        s_own = jnp.einsum('bhqd,bhkd->bhqk', qch, k_own).astype(jnp.float32) * scale
        s_own = jnp.where(kpos_own[None, :] <= qpos[:, None], s_own, -jnp.inf)
        p = jax.nn.softmax(jnp.concatenate([s_sel, s_own], axis=-1), axis=-1).astype(v.dtype)
        p_sel = p[..., :topk * BS].reshape(B, H, QC, topk, BS)
        p_own = p[..., topk * BS:]
        return (jnp.einsum('bhqjk,bhqjkd->bhqd', p_sel, v_sel)
                + jnp.einsum('bhqk,bhkd->bhqd', p_own, v_own))

    o = lax.map(one_chunk, (qc, jnp.arange(nc)))
    return o.transpose(1, 0, 3, 2, 4).reshape(B, S, MOBA_WIDTH)


def setup_inputs(seed: int = 0) -> dict:
    key = jax.random.key(seed)
    ks = jax.random.split(key, 12)
    L, D = DEPTH, D_MODEL
    x = jax.random.normal(ks[0], (BATCH, SEQ, D), jnp.float32)
    w_in = jax.random.normal(ks[1], (L, D, 3 * MIX_WIDTH), jnp.float32) * D ** -0.5
    col = jnp.arange(3 * MIX_WIDTH)
    is_v = ((col >= 2 * DIFF_WIDTH) & (col < 3 * DIFF_WIDTH)) | (col >= 3 * DIFF_WIDTH + 2 * MOBA_WIDTH)
    w_in = w_in * jnp.where(is_v, BETA, 1.0).astype(jnp.float32)
    diff_lambda = jax.random.normal(ks[2], (L, 4, HEAD_DIM), jnp.float32) * 0.1
    diff_subln_g = 1.0 + 0.02 * jax.random.normal(ks[3], (L, 2 * HEAD_DIM), jnp.float32)
    w_o = jax.random.normal(ks[4], (L, MIX_WIDTH, D), jnp.float32) * MIX_WIDTH ** -0.5 * BETA
    ln1_g = 1.0 + 0.02 * jax.random.normal(ks[5], (L, D), jnp.float32)
    ln1_b = 0.02 * jax.random.normal(ks[6], (L, D), jnp.float32)
    w_ffn_in = jax.random.normal(ks[7], (L, D, 2 * D_FF), jnp.float32) * D ** -0.5 * BETA
    w_ffn_out = jax.random.normal(ks[8], (L, D_FF, D), jnp.float32) * D_FF ** -0.5 * BETA
    ln2_g = 1.0 + 0.02 * jax.random.normal(ks[9], (L, D), jnp.float32)
    ln2_b = 0.02 * jax.random.normal(ks[10], (L, D), jnp.float32)
    return {"x": x, "w_in": w_in, "diff_lambda": diff_lambda, "diff_subln_g": diff_subln_g,
            "w_o": w_o, "ln1_g": ln1_g, "ln1_b": ln1_b, "w_ffn_in": w_ffn_in,
            "w_ffn_out": w_ffn_out, "ln2_g": ln2_g, "ln2_b": ln2_b}


def reference(x, w_in, diff_lambda, diff_subln_g, w_o, ln1_g, ln1_b, w_ffn_in, w_ffn_out, ln2_g, ln2_b):
    S = x.shape[1]
    cos, sin = rope_tables(S)
    splits = [DIFF_WIDTH, 2 * DIFF_WIDTH, 3 * DIFF_WIDTH,
              3 * DIFF_WIDTH + MOBA_WIDTH, 3 * DIFF_WIDTH + 2 * MOBA_WIDTH]
    for l in range(DEPTH):
        lambda_init = lambda_init_for(l)
        proj = jnp.einsum('bsd,de->bse', x, w_in[l])
        dq, dk, dv, mq, mk, mv = jnp.split(proj, splits, axis=-1)
        a_out = diff_attention(dq, dk, dv, diff_lambda[l], diff_subln_g[l], lambda_init, cos, sin)
        b_out = moba_attention(mq, mk, mv, cos, sin)
        mix = jnp.einsum('bse,ed->bsd', jnp.concatenate([a_out, b_out], axis=-1), w_o[l])
        x = layer_norm(ALPHA * x + mix, ln1_g[l], ln1_b[l])
        gu = jnp.einsum('bsd,df->bsf', x, w_ffn_in[l])
        g, u = jnp.split(gu, 2, axis=-1)
        f = jnp.einsum('bsf,fd->bsd', jax.nn.silu(g) * u, w_ffn_out[l])
        x = layer_norm(ALPHA * x + f, ln2_g[l], ln2_b[l])
    return x
```

```cpp
#include <hip/hip_runtime.h>
#include <cstdio>
#include <cstdint>
#include <cmath>

namespace v0 {
constexpr int D = 1024, BATCH = 4, SEQ = 4096, NPROJ = 3072, DFF = 2816;
constexpr float LN_EPS = 1e-5f;
constexpr float ALPHA = 1.189207115002721f;
constexpr float LAMBDA_INIT = 0.2f;

__global__ void __launch_bounds__(256) gemm_f32(const float* __restrict__ A, int lda, const float* __restrict__ B, int ldb, float* __restrict__ C, int ldc, int K) {
    __shared__ float As[16][64 + 4];
    __shared__ float Bs[16][64 + 4];
    const int t = threadIdx.x, ty = t >> 4, tx = t & 15;
    const int m0 = blockIdx.y * 64, n0 = blockIdx.x * 64;
    float acc[4][4];
#pragma unroll
    for (int i = 0; i < 4; ++i)
#pragma unroll
        for (int j = 0; j < 4; ++j) acc[i][j] = 0.f;
    for (int k0 = 0; k0 < K; k0 += 16) {
        { const int r = t >> 2, c = (t & 3) * 4; const float4 v = *(const float4*)(A + (size_t)(m0 + r) * lda + k0 + c);
          As[c + 0][r] = v.x; As[c + 1][r] = v.y; As[c + 2][r] = v.z; As[c + 3][r] = v.w; }
        { const int r = t >> 4, c = (t & 15) * 4; const float4 v = *(const float4*)(B + (size_t)(k0 + r) * ldb + n0 + c);
          *(float4*)&Bs[r][c] = v; }
        __syncthreads();
#pragma unroll
        for (int k = 0; k < 16; ++k) {
            const float4 a = *(const float4*)&As[k][ty * 4]; const float4 b = *(const float4*)&Bs[k][tx * 4];
            const float av[4] = {a.x, a.y, a.z, a.w}, bv[4] = {b.x, b.y, b.z, b.w};
#pragma unroll
            for (int i = 0; i < 4; ++i)
#pragma unroll
                for (int j = 0; j < 4; ++j) acc[i][j] = fmaf(av[i], bv[j], acc[i][j]);
        }
        __syncthreads();
    }
#pragma unroll
    for (int i = 0; i < 4; ++i) *(float4*)(C + (size_t)(m0 + ty * 4 + i) * ldc + n0 + tx * 4) = make_float4(acc[i][0], acc[i][1], acc[i][2], acc[i][3]);
}

__global__ void rope_kernel(float* __restrict__ proj) {
    const int idx = blockIdx.x * blockDim.x + threadIdx.x;
    if (idx >= SEQ * 256) return;
    const int i = idx & 7, hh = (idx >> 3) & 31, pos = idx >> 8;
    const int grp = hh >> 3, hl = hh & 7;
    const int colbase = (grp == 0 ? 0 : grp == 1 ? 512 : grp == 2 ? 1536 : 2048) + hl * 64;
    const float inv = (float)pow(500000.0, -(double)i / 8.0);
    const float ang = (float)pos * inv;
    const float c = cosf(ang), s = sinf(ang);
    float* p = proj + (size_t)pos * NPROJ + colbase;
    const float x1 = p[i], x2 = p[i + 8];
    p[i] = x1 * c - x2 * s; p[i + 8] = x2 * c + x1 * s;
}

__global__ void kmean_kernel(const float* __restrict__ proj, float* __restrict__ kmean) {
    const int h = blockIdx.x >> 4, n = blockIdx.x & 15, d = threadIdx.x;
    float s = 0.f;
    for (int r = 0; r < 256; ++r) s += proj[(size_t)(n * 256 + r) * NPROJ + 2048 + h * 64 + d];
    kmean[(h * 16 + n) * 64 + d] = s * (1.f / 256.f);
}

template <int DV>
__device__ __forceinline__ void attn_rows(const float* __restrict__ proj, int qcol, int kcol, int vcol, int q0, unsigned selmask, int own, bool moba, float (&o)[DV], float* Ks, float* Vs) {
    const int t = threadIdx.x, pos = q0 + t;
    float q[64];
#pragma unroll
    for (int d = 0; d < 64; d += 4) { const float4 v = *(const float4*)(proj + (size_t)pos * NPROJ + qcol + d); q[d] = v.x * 0.125f; q[d + 1] = v.y * 0.125f; q[d + 2] = v.z * 0.125f; q[d + 3] = v.w * 0.125f; }
#pragma unroll
    for (int d = 0; d < DV; ++d) o[d] = 0.f;
    float m = -INFINITY, l = 0.f;
    const int ntiles = (q0 + 256) / 16;
    for (int kt = 0; kt < ntiles; ++kt) {
        const int k0 = kt * 16;
        __syncthreads();
        { const int r = t >> 4, c = (t & 15) * 4; *(float4*)(Ks + r * 64 + c) = *(const float4*)(proj + (size_t)(k0 + r) * NPROJ + kcol + c); }
        if (DV == 128) {
#pragma unroll
            for (int i = 0; i < 2; ++i) { const int e = t + i * 256, r = e >> 5, c = (e & 31) * 4; *(float4*)(Vs + r * 128 + c) = *(const float4*)(proj + (size_t)(k0 + r) * NPROJ + vcol + c); }
        } else {
            const int r = t >> 4, c = (t & 15) * 4; *(float4*)(Vs + r * 64 + c) = *(const float4*)(proj + (size_t)(k0 + r) * NPROJ + vcol + c);
        }
        __syncthreads();
        bool active = true;
        if (moba) { const int jb = k0 >> 8; active = (jb == own) || ((selmask >> jb) & 1u); }
        if (k0 > pos) active = false;
        if (active) {
            float s[16]; float tm = -INFINITY;
#pragma unroll
            for (int j = 0; j < 16; ++j) {
                float a = 0.f;
#pragma unroll
                for (int d = 0; d < 64; d += 4) { const float4 kv = *(const float4*)(Ks + j * 64 + d); a = fmaf(q[d], kv.x, a); a = fmaf(q[d + 1], kv.y, a); a = fmaf(q[d + 2], kv.z, a); a = fmaf(q[d + 3], kv.w, a); }
                if (k0 + j > pos) a = -INFINITY;
                s[j] = a; tm = fmaxf(tm, a);
            }
            const float mn = fmaxf(m, tm);
            const float f = expf(m - mn);
            l *= f;
#pragma unroll
            for (int d = 0; d < DV; ++d) o[d] *= f;
            m = mn;
#pragma unroll
            for (int j = 0; j < 16; ++j) {
                const float p = expf(s[j] - mn); l += p;
#pragma unroll
                for (int d = 0; d < DV; d += 4) { const float4 vv = *(const float4*)(Vs + j * DV + d); o[d] = fmaf(p, vv.x, o[d]); o[d + 1] = fmaf(p, vv.y, o[d + 1]); o[d + 2] = fmaf(p, vv.z, o[d + 2]); o[d + 3] = fmaf(p, vv.w, o[d + 3]); }
            }
        }
    }
    const float rl = 1.f / l;
#pragma unroll
    for (int d = 0; d < DV; ++d) o[d] *= rl;
}

__global__ void __launch_bounds__(256) diff_attn_kernel(const float* __restrict__ proj, const float* __restrict__ lamp, const float* __restrict__ subg, float* __restrict__ tmp, float* __restrict__ mixin) {
    __shared__ float Ks[16 * 64];
    __shared__ float Vs[16 * 128];
    const int h = blockIdx.y, q0 = blockIdx.x * 256, t = threadIdx.x, pos = q0 + t;
    float d01 = 0.f, d23 = 0.f;
    for (int i = 0; i < 64; ++i) { d01 += lamp[i] * lamp[64 + i]; d23 += lamp[128 + i] * lamp[192 + i]; }
    const float lam = expf(d01) - expf(d23) + LAMBDA_INIT;
    float o[128];
    float* trow = tmp + ((size_t)h * SEQ + pos) * 128;
    attn_rows<128>(proj, h * 128, 512 + h * 128, 1024 + h * 128, q0, 0u, 0, false, o, Ks, Vs);
#pragma unroll
    for (int d = 0; d < 128; d += 4) *(float4*)(trow + d) = make_float4(o[d], o[d + 1], o[d + 2], o[d + 3]);
    attn_rows<128>(proj, h * 128 + 64, 512 + h * 128 + 64, 1024 + h * 128, q0, 0u, 0, false, o, Ks, Vs);
    float ss = 0.f;
#pragma unroll
    for (int d = 0; d < 128; d += 4) { const float4 a = *(const float4*)(trow + d); o[d] = a.x - lam * o[d]; o[d + 1] = a.y - lam * o[d + 1]; o[d + 2] = a.z - lam * o[d + 2]; o[d + 3] = a.w - lam * o[d + 3];
        ss += o[d] * o[d] + o[d + 1] * o[d + 1] + o[d + 2] * o[d + 2] + o[d + 3] * o[d + 3]; }
    const float r = 1.f / sqrtf(ss * (1.f / 128.f) + LN_EPS);
    float* orow = mixin + (size_t)pos * D + h * 128;
#pragma unroll
    for (int d = 0; d < 128; ++d) orow[d] = o[d] * r * subg[d] * (1.f - LAMBDA_INIT);
}

__global__ void __launch_bounds__(256) moba_attn_kernel(const float* __restrict__ proj, const float* __restrict__ kmean, float* __restrict__ mixin) {
    __shared__ float Ks[16 * 64];
    __shared__ float Vs[16 * 64];
    const int h = blockIdx.y, q0 = blockIdx.x * 256, t = threadIdx.x, pos = q0 + t, own = q0 >> 8;
    unsigned sel = 0u;
    if (own <= 3) sel = (1u << own) - 1u;
    else {
        float g[16];
#pragma unroll
        for (int n = 0; n < 16; ++n) g[n] = -INFINITY;
        for (int n = 0; n < own; ++n) {
            float a = 0.f;
            for (int d = 0; d < 64; ++d) a = fmaf(proj[(size_t)pos * NPROJ + 1536 + h * 64 + d], kmean[(h * 16 + n) * 64 + d], a);
#pragma unroll
            for (int k = 0; k < 16; ++k) if (k == n) g[k] = a;
        }
        for (int r = 0; r < 3; ++r) {
            float best = -INFINITY; int bi = 0;
#pragma unroll
            for (int n = 0; n < 16; ++n) if (!((sel >> n) & 1u) && g[n] > best) { best = g[n]; bi = n; }
            sel |= 1u << bi;
        }
    }
    float o[64];
    attn_rows<64>(proj, 1536 + h * 64, 2048 + h * 64, 2560 + h * 64, q0, sel, own, true, o, Ks, Vs);
    float* orow = mixin + (size_t)pos * D + 512 + h * 64;
#pragma unroll
    for (int d = 0; d < 64; d += 4) *(float4*)(orow + d) = make_float4(o[d], o[d + 1], o[d + 2], o[d + 3]);
}

__global__ void __launch_bounds__(256) ln_res_kernel(const float* res, const float* __restrict__ add, const float* __restrict__ g, const float* __restrict__ b, float* out, int rows) {
    const int row = blockIdx.x * 4 + (threadIdx.x >> 6), lane = threadIdx.x & 63;
    if (row >= rows) return;
    float v[16]; float s = 0.f;
#pragma unroll
    for (int j = 0; j < 4; ++j) { const float4 r4 = *(const float4*)(res + (size_t)row * D + j * 256 + lane * 4), a4 = *(const float4*)(add + (size_t)row * D + j * 256 + lane * 4);
        v[j * 4] = ALPHA * r4.x + a4.x; v[j * 4 + 1] = ALPHA * r4.y + a4.y; v[j * 4 + 2] = ALPHA * r4.z + a4.z; v[j * 4 + 3] = ALPHA * r4.w + a4.w;
        s += v[j * 4] + v[j * 4 + 1] + v[j * 4 + 2] + v[j * 4 + 3]; }
#pragma unroll
    for (int o = 1; o < 64; o <<= 1) s += __shfl_xor(s, o);
    const float mean = s * (1.f / D); float q = 0.f;
#pragma unroll
    for (int i = 0; i < 16; ++i) { v[i] -= mean; q += v[i] * v[i]; }
#pragma unroll
    for (int o = 1; o < 64; o <<= 1) q += __shfl_xor(q, o);
    const float rstd = 1.f / sqrtf(q * (1.f / D) + LN_EPS);
#pragma unroll
    for (int j = 0; j < 4; ++j) { const int c = j * 256 + lane * 4; const float4 g4 = *(const float4*)(g + c), b4 = *(const float4*)(b + c);
        *(float4*)(out + (size_t)row * D + c) = make_float4(v[j * 4] * rstd * g4.x + b4.x, v[j * 4 + 1] * rstd * g4.y + b4.y, v[j * 4 + 2] * rstd * g4.z + b4.z, v[j * 4 + 3] * rstd * g4.w + b4.w); }
}

__global__ void silu_mul_kernel(const float* __restrict__ gu, float* __restrict__ h, int rows) {
    const size_t idx = (size_t)blockIdx.x * blockDim.x + threadIdx.x;
    if (idx >= (size_t)rows * DFF) return;
    const size_t row = idx / DFF, j = idx % DFF;
    const float g = gu[row * 2 * DFF + j], u = gu[row * 2 * DFF + DFF + j];
    h[idx] = g / (1.f + expf(-g)) * u;
}
}

extern "C" void kernel_launch(void* const* d_in, const int* in_sizes, int n_in, void* d_out, int out_size, void* d_ws, size_t ws_size, hipStream_t stream) {
    using namespace v0;
    const float* x = (const float*)d_in[0]; const float* w_in = (const float*)d_in[1]; const float* lamp = (const float*)d_in[2]; const float* subg = (const float*)d_in[3];
    const float* w_o = (const float*)d_in[4]; const float* ln1g = (const float*)d_in[5]; const float* ln1b = (const float*)d_in[6]; const float* w_fi = (const float*)d_in[7];
    const float* w_fo = (const float*)d_in[8]; const float* ln2g = (const float*)d_in[9]; const float* ln2b = (const float*)d_in[10];
    float* out = (float*)d_out;
    float* ws = (float*)d_ws;
    float* proj = ws;
    float* mixin = proj + (size_t)SEQ * NPROJ;
    float* tmp = mixin + (size_t)SEQ * D;
    float* kmean = tmp + (size_t)4 * SEQ * 128;
    float* mixo = kmean + 8192;
    float* gu = mixo + (size_t)SEQ * D;
    float* hbuf = gu + (size_t)SEQ * 2 * DFF;
    float* fbuf = hbuf + (size_t)SEQ * DFF;
    for (int b = 0; b < BATCH; ++b) {
        const float* xb = x + (size_t)b * SEQ * D; float* ob = out + (size_t)b * SEQ * D;
        gemm_f32<<<dim3(NPROJ / 64, SEQ / 64), 256, 0, stream>>>(xb, D, w_in, NPROJ, proj, NPROJ, D);
        rope_kernel<<<SEQ * 256 / 256, 256, 0, stream>>>(proj);
        kmean_kernel<<<8 * 16, 64, 0, stream>>>(proj, kmean);
        diff_attn_kernel<<<dim3(SEQ / 256, 4), 256, 0, stream>>>(proj, lamp, subg, tmp, mixin);
        moba_attn_kernel<<<dim3(SEQ / 256, 8), 256, 0, stream>>>(proj, kmean, mixin);
        gemm_f32<<<dim3(D / 64, SEQ / 64), 256, 0, stream>>>(mixin, D, w_o, D, mixo, D, D);
        ln_res_kernel<<<SEQ / 4, 256, 0, stream>>>(xb, mixo, ln1g, ln1b, ob, SEQ);
        gemm_f32<<<dim3(2 * DFF / 64, SEQ / 64), 256, 0, stream>>>(ob, D, w_fi, 2 * DFF, gu, 2 * DFF, D);
        silu_mul_kernel<<<(unsigned)(((size_t)SEQ * DFF + 255) / 256), 256, 0, stream>>>(gu, hbuf, SEQ);
        gemm_f32<<<dim3(D / 64, SEQ / 64), 256, 0, stream>>>(hbuf, DFF, w_fo, D, fbuf, D, DFF);
        ln_res_kernel<<<SEQ / 4, 256, 0, stream>>>(ob, fbuf, ln2g, ln2b, ob, SEQ);
    }
}
```
